# Optimizing an MI355X kernel written in HIP

```python
import math
import jax, jax.numpy as jnp
from jax import lax
import numpy as np

D_MODEL = 2048
BATCH = 1
SEQ = 8192
DEPTH = 2

S5_WIDTH = D_MODEL // 2
S5_GROUP = 16
S5_GROUPS = S5_WIDTH // S5_GROUP
S5_STATE = 64
RET_WIDTH = D_MODEL // 2
RET_HEADS = 4
RET_HEAD_DIM = RET_WIDTH // RET_HEADS
RET_CHUNK = 128
RET_ROPE_THETA = 10000.0
EVEN_IN_WIDTH = S5_WIDTH + 4 * RET_WIDTH
ATT_HEADS = 16
ATT_KV_HEADS = 4
ATT_HEAD_DIM = D_MODEL // ATT_HEADS
ATT_GROUP = ATT_HEADS // ATT_KV_HEADS
ATT_WINDOW = 128
ATT_BLOCK = 128
ROPE_THETA = 500000.0
ROPE_DIM = ATT_HEAD_DIM // 4
ODD_IN_WIDTH = (ATT_HEADS + 2 * ATT_KV_HEADS) * ATT_HEAD_DIM
D_FF = 4 * D_MODEL
N_EVEN = (DEPTH + 1) // 2
N_ODD = DEPTH // 2
DEEPNORM_ALPHA = (2 * DEPTH) ** 0.25
DEEPNORM_BETA = (8 * DEPTH) ** -0.25
LN_EPS = 1e-5
HEAD_NORM_EPS = 1e-6
NEG_INF = -1e30

kernel_name = 'hybrid_s5_retention_swa_encoder'

F32 = jnp.float32


def _layer_norm(x, g, b):
    xf = x.astype(F32)
    mu = xf.mean(-1, keepdims=True)
    var = jnp.square(xf - mu).mean(-1, keepdims=True)
    return ((xf - mu) * lax.rsqrt(var + LN_EPS) * g.astype(F32) + b.astype(F32)).astype(x.dtype)


def _sq_relu_mlp(x, w1, w2):
    return jnp.square(jax.nn.relu(x @ w1)) @ w2


def _rotary(x, pos, rot_dim, theta):
    half = rot_dim // 2
    inv_freq = 1.0 / (theta ** (jnp.arange(half, dtype=F32) / half))
    ang = pos.astype(F32)[:, None] * inv_freq[None, :]
    cos = jnp.cos(ang)[None, :, None, :]
    sin = jnp.sin(ang)[None, :, None, :]
    xr = x[..., :rot_dim].astype(F32)
    x1, x2 = xr[..., :half], xr[..., half:]
    rot = jnp.concatenate([x1 * cos - x2 * sin, x2 * cos + x1 * sin], axis=-1).astype(x.dtype)
    return jnp.concatenate([rot, x[..., rot_dim:]], axis=-1)


def _cplx_combine(e1, e2):
    a1r, a1i, b1r, b1i = e1
    a2r, a2i, b2r, b2i = e2
    return (a2r * a1r - a2i * a1i,
            a2r * a1i + a2i * a1r,
            a2r * b1r - a2i * b1i + b2r,
            a2r * b1i + a2i * b1r + b2i)


def _s5_scan(u, lam_re, lam_im, log_step, b_re, b_im, c_re, c_im):
    lam_re = jnp.minimum(lam_re.astype(F32), -1e-4)
    lam_im = lam_im.astype(F32)
    step = jnp.exp(log_step.astype(F32))[:, None]
    mag = jnp.exp(lam_re * step)
    ar = mag * jnp.cos(lam_im * step)
    ai = mag * jnp.sin(lam_im * step)
    nr, ni = ar - 1.0, ai
    den = lam_re * lam_re + lam_im * lam_im
    zr = (nr * lam_re + ni * lam_im) / den
    zi = (ni * lam_re - nr * lam_im) / den
    b_re = b_re.astype(F32)
    b_im = b_im.astype(F32)
    bbr = zr[..., None] * b_re - zi[..., None] * b_im
    bbi = zr[..., None] * b_im + zi[..., None] * b_re
    bu_r = jnp.einsum('blgc,gpc->blgp', u, bbr)
    bu_i = jnp.einsum('blgc,gpc->blgp', u, bbi)
    a_r = jnp.broadcast_to(ar, bu_r.shape)
    a_i = jnp.broadcast_to(ai, bu_r.shape)
    _, _, h_r, h_i = lax.associative_scan(_cplx_combine, (a_r, a_i, bu_r, bu_i), axis=1)
    return (jnp.einsum('gcp,blgp->blgc', c_re.astype(F32), h_r)
            - jnp.einsum('gcp,blgp->blgc', c_im.astype(F32), h_i))


def _retention_dir(q, k, v, log_g, include_diag):
    bsz, L, H, dk = q.shape
    dv = v.shape[-1]
    C = RET_CHUNK
    nc = L // C
    qc = q.reshape(bsz, nc, C, H, dk)
    kc = k.reshape(bsz, nc, C, H, dk)
    vc = v.reshape(bsz, nc, C, H, dv)
    idx = jnp.arange(C)
    diff = idx[:, None] - idx[None, :]
    mask = diff >= 0 if include_diag else diff > 0
    decay_intra = jnp.where(mask[None],
                            jnp.exp(log_g[:, None, None] * jnp.maximum(diff, 0)[None].astype(F32)),
                            0.0)
    scores = jnp.einsum('bnihd,bnjhd->bnhij', qc, kc) * decay_intra
    intra = jnp.einsum('bnhij,bnjhe->bnihe', scores, vc)
    idx_f = idx.astype(F32)
    k_decay = jnp.exp((C - 1.0 - idx_f)[:, None] * log_g[None, :])
    q_decay = jnp.exp((idx_f + 1.0)[:, None] * log_g[None, :])
    chunk_decay = jnp.exp(C * log_g)
    chunk_kv = jnp.einsum('bnjhd,jh,bnjhe->bnhde', kc, k_decay, vc)

    def step(state, kv):
        return state * chunk_decay[None, :, None, None] + kv, state

    init = jnp.zeros((bsz, H, dk, dv), F32)
    _, s_prev = lax.scan(step, init, jnp.moveaxis(chunk_kv, 1, 0))
    s_prev = jnp.moveaxis(s_prev, 0, 1)
    cross = jnp.einsum('bnihd,ih,bnhde->bnihe', qc, q_decay, s_prev)
    return (intra + cross).reshape(bsz, L, H, dv)


def _even_mixer(x, w_in, w_out, lam_re, lam_im, log_step, b_re, b_im, c_re, c_im,
                d_skip, w_glu, b_glu, ret_log_decay):
    bsz, L, _ = x.shape
    pos = jnp.arange(L)
    h = x @ w_in
    u = h[..., :S5_WIDTH]
    q, k, v, gate = jnp.split(h[..., S5_WIDTH:], 4, axis=-1)

    uf = u.astype(F32).reshape(bsz, L, S5_GROUPS, S5_GROUP)
    y_fwd = _s5_scan(uf, lam_re[0], lam_im[0], log_step[0], b_re[0], b_im[0], c_re[0], c_im[0])
    y_bwd = jnp.flip(_s5_scan(jnp.flip(uf, 1), lam_re[1], lam_im[1], log_step[1],
                              b_re[1], b_im[1], c_re[1], c_im[1]), 1)
    y = jax.nn.gelu((y_fwd + y_bwd + d_skip.astype(F32) * uf).reshape(bsz, L, S5_WIDTH))
    s5_out = (y * jax.nn.sigmoid(y @ w_glu.astype(F32) + b_glu.astype(F32))).astype(x.dtype)

    q = _rotary(q.reshape(bsz, L, RET_HEADS, RET_HEAD_DIM), pos, RET_HEAD_DIM, RET_ROPE_THETA).astype(F32)
    k = _rotary(k.reshape(bsz, L, RET_HEADS, RET_HEAD_DIM), pos, RET_HEAD_DIM, RET_ROPE_THETA).astype(F32)
    k = k * (RET_HEAD_DIM ** -0.5)
    v = v.reshape(bsz, L, RET_HEADS, RET_HEAD_DIM).astype(F32)
    log_g = -jnp.abs(ret_log_decay.astype(F32))
    o = (_retention_dir(q, k, v, log_g[0], True)
         + jnp.flip(_retention_dir(jnp.flip(q, 1), jnp.flip(k, 1), jnp.flip(v, 1), log_g[1], False), 1))
    mu = o.mean(-1, keepdims=True)
    var = jnp.square(o - mu).mean(-1, keepdims=True)
    o = (o - mu) * lax.rsqrt(var + HEAD_NORM_EPS)
    ret_out = (o.reshape(bsz, L, RET_WIDTH) * jax.nn.silu(gate.astype(F32))).astype(x.dtype)

    return jnp.concatenate([s5_out, ret_out], axis=-1) @ w_out


def _band(t, bsz, nb):
    tb = t.reshape(bsz, nb, ATT_BLOCK, ATT_KV_HEADS, ATT_HEAD_DIM)
    tp = jnp.pad(tb, ((0, 0), (1, 1), (0, 0), (0, 0), (0, 0)))
    return jnp.concatenate([tp[:, :-2], tp[:, 1:-1], tp[:, 2:]], axis=2)


def _odd_mixer(x, w_in, w_out, sink):
    bsz, L, _ = x.shape
    nb = L // ATT_BLOCK
    pos = jnp.arange(L)
    hd = ATT_HEAD_DIM
    h = x @ w_in
    q = h[..., :ATT_HEADS * hd].reshape(bsz, L, ATT_HEADS, hd)
    k = h[..., ATT_HEADS * hd:(ATT_HEADS + ATT_KV_HEADS) * hd].reshape(bsz, L, ATT_KV_HEADS, hd)
    v = h[..., (ATT_HEADS + ATT_KV_HEADS) * hd:].reshape(bsz, L, ATT_KV_HEADS, hd)
    q = _rotary(q, pos, ROPE_DIM, ROPE_THETA)
    k = _rotary(k, pos, ROPE_DIM, ROPE_THETA)
    qb = q.reshape(bsz, nb, ATT_BLOCK, ATT_KV_HEADS, ATT_GROUP, hd)
    kb = _band(k, bsz, nb)
    vb = _band(v, bsz, nb)
    s = jnp.einsum('bnqhgd,bnkhd->bnhgqk', qb, kb).astype(F32) * (hd ** -0.5)
    t_idx = jnp.arange(ATT_BLOCK)[:, None]
    s_idx = jnp.arange(3 * ATT_BLOCK)[None, :]
    in_win = jnp.abs(t_idx - s_idx + ATT_BLOCK) <= ATT_WINDOW
    key_pos = (jnp.arange(nb)[:, None] - 1) * ATT_BLOCK + jnp.arange(3 * ATT_BLOCK)[None, :]
    valid = (key_pos >= 0) & (key_pos < L)
    mask = in_win[None] & valid[:, None, :]
    s = jnp.where(mask[None, :, None, None], s, NEG_INF)
    sink_b = sink.astype(F32).reshape(1, 1, ATT_KV_HEADS, ATT_GROUP, 1, 1)
    m = jnp.maximum(s.max(-1, keepdims=True), sink_b)
    p = jnp.exp(s - m)
    p = p / (p.sum(-1, keepdims=True) + jnp.exp(sink_b - m))
    o = jnp.einsum('bnhgqk,bnkhd->bnqhgd', p.astype(vb.dtype), vb)
    return o.reshape(bsz, L, ATT_HEADS * hd) @ w_out


def setup_inputs(seed: int = 0) -> dict:
    key = jax.random.key(seed)
    ks = jax.random.split(key, 24)
    nrm = jax.random.normal
    G, P, Cg = S5_GROUPS, S5_STATE, S5_GROUP
    x = nrm(ks[0], (BATCH, SEQ, D_MODEL), F32)
    ln_g = 1.0 + 0.02 * nrm(ks[1], (DEPTH, 2, D_MODEL), F32)
    ln_b = 0.02 * nrm(ks[2], (DEPTH, 2, D_MODEL), F32)
    mlp_w1 = nrm(ks[3], (DEPTH, D_MODEL, D_FF), F32) * D_MODEL ** -0.5
    mlp_w2 = nrm(ks[4], (DEPTH, D_FF, D_MODEL), F32) * (D_FF ** -0.5 * DEEPNORM_BETA)
    even_w_in = nrm(ks[5], (N_EVEN, D_MODEL, EVEN_IN_WIDTH), F32) * D_MODEL ** -0.5
    even_w_out = nrm(ks[6], (N_EVEN, S5_WIDTH + RET_WIDTH, D_MODEL), F32) * ((S5_WIDTH + RET_WIDTH) ** -0.5 * DEEPNORM_BETA)
    n_idx = jnp.arange(P, dtype=F32)
    s5_lambda_re = -0.5 * (1.0 + 0.02 * nrm(ks[7], (N_EVEN, 2, G, P), F32))
    s5_lambda_im = math.pi * n_idx + 0.02 * nrm(ks[8], (N_EVEN, 2, G, P), F32)
    s5_log_step = jax.random.uniform(ks[9], (N_EVEN, 2, G), F32, math.log(1e-3), math.log(1e-1))
    s5_b_re = nrm(ks[10], (N_EVEN, 2, G, P, Cg), F32) * (2 * Cg) ** -0.5
    s5_b_im = nrm(ks[11], (N_EVEN, 2, G, P, Cg), F32) * (2 * Cg) ** -0.5
    s5_c_re = nrm(ks[12], (N_EVEN, 2, G, Cg, P), F32) * P ** -0.5
    s5_c_im = nrm(ks[13], (N_EVEN, 2, G, Cg, P), F32) * P ** -0.5
    s5_d = nrm(ks[14], (N_EVEN, G, Cg), F32)
    s5_w_glu = nrm(ks[15], (N_EVEN, S5_WIDTH, S5_WIDTH), F32) * S5_WIDTH ** -0.5
    s5_b_glu = 0.01 * nrm(ks[16], (N_EVEN, S5_WIDTH), F32)
    base_decay = jnp.log(1.0 - 2.0 ** (-5.0 - jnp.arange(RET_HEADS, dtype=F32)))
    ret_log_decay = base_decay * (1.0 + 0.05 * nrm(ks[17], (N_EVEN, 2, RET_HEADS), F32))
    odd_w_in = nrm(ks[18], (N_ODD, D_MODEL, ODD_IN_WIDTH), F32) * D_MODEL ** -0.5
    odd_w_out = nrm(ks[19], (N_ODD, ATT_HEADS * ATT_HEAD_DIM, D_MODEL), F32) * ((ATT_HEADS * ATT_HEAD_DIM) ** -0.5 * DEEPNORM_BETA)
    attn_sink = 0.5 * nrm(ks[20], (N_ODD, ATT_HEADS), F32)
    return {'x': x, 'ln_g': ln_g, 'ln_b': ln_b, 'mlp_w1': mlp_w1, 'mlp_w2': mlp_w2,
            'even_w_in': even_w_in, 'even_w_out': even_w_out,
            's5_lambda_re': s5_lambda_re, 's5_lambda_im': s5_lambda_im, 's5_log_step': s5_log_step,
            's5_b_re': s5_b_re, 's5_b_im': s5_b_im, 's5_c_re': s5_c_re, 's5_c_im': s5_c_im,
            's5_d': s5_d, 's5_w_glu': s5_w_glu, 's5_b_glu': s5_b_glu, 'ret_log_decay': ret_log_decay,
            'odd_w_in': odd_w_in, 'odd_w_out': odd_w_out, 'attn_sink': attn_sink}


def reference(x, ln_g, ln_b, mlp_w1, mlp_w2, even_w_in, even_w_out,
              s5_lambda_re, s5_lambda_im, s5_log_step, s5_b_re, s5_b_im, s5_c_re, s5_c_im,
              s5_d, s5_w_glu, s5_b_glu, ret_log_decay, odd_w_in, odd_w_out, attn_sink):
    for layer in range(DEPTH):
        if layer % 2 == 0:
            e = layer // 2
            mix = _even_mixer(x, even_w_in[e], even_w_out[e], s5_lambda_re[e], s5_lambda_im[e],
                              s5_log_step[e], s5_b_re[e], s5_b_im[e], s5_c_re[e], s5_c_im[e],
                              s5_d[e], s5_w_glu[e], s5_b_glu[e], ret_log_decay[e])
        else:
            o = layer // 2
            mix = _odd_mixer(x, odd_w_in[o], odd_w_out[o], attn_sink[o])
        x = _layer_norm(DEEPNORM_ALPHA * x + mix, ln_g[layer, 0], ln_b[layer, 0])
        x = _layer_norm(DEEPNORM_ALPHA * x + _sq_relu_mlp(x, mlp_w1[layer], mlp_w2[layer]),
                        ln_g[layer, 1], ln_b[layer, 1])
    return x
```

```cpp
#include <hip/hip_runtime.h>
#include <cstdio>
#include <cstdint>
namespace nv {
constexpr int L = 8192, D = 2048, DFF = 8192, EW = 5120, OW = 3072;
constexpr float ALPHA = 1.4142135623730951f;

__device__ __forceinline__ float gelu_tanh(float x) {
    const float k = 0.7978845608028654f;
    float u = k * (x + 0.044715f * x * x * x);
    return 0.5f * x * (1.0f + tanhf(u));
}
__device__ __forceinline__ float sigmoidf_(float x) { return 1.0f / (1.0f + expf(-x)); }

template <int EPI>
__global__ void __launch_bounds__(256) gemm_naive(const float* __restrict__ A, int lda, const float* __restrict__ B, int ldb,
                                                  float* C, int ldc, int K, const float* R, int ldr, float alpha, const float* bias) {
    __shared__ float As[16][128 + 4];
    __shared__ float Bs[16][128 + 4];
    const int tid = threadIdx.x, tx = tid & 15, ty = tid >> 4;
    const int m0 = blockIdx.y * 128, n0 = blockIdx.x * 128;
    float acc[8][8];
#pragma unroll
    for (int i = 0; i < 8; ++i)
#pragma unroll
        for (int j = 0; j < 8; ++j) acc[i][j] = 0.f;
    for (int k0 = 0; k0 < K; k0 += 16) {
#pragma unroll
        for (int i = 0; i < 2; ++i) {
            const int m = (tid >> 2) + 64 * i, kk = (tid & 3) * 4;
            const float4 v = *(const float4*)(A + (size_t)(m0 + m) * lda + k0 + kk);
            As[kk + 0][m] = v.x; As[kk + 1][m] = v.y; As[kk + 2][m] = v.z; As[kk + 3][m] = v.w;
        }
#pragma unroll
        for (int i = 0; i < 2; ++i) {
            const int kk = (tid >> 5) + 8 * i, n = (tid & 31) * 4;
            const float4 v = *(const float4*)(B + (size_t)(k0 + kk) * ldb + n0 + n);
            *(float4*)&Bs[kk][n] = v;
        }
        __syncthreads();
#pragma unroll
        for (int kk = 0; kk < 16; ++kk) {
            float a[8], b[8];
            const float4 a0 = *(const float4*)&As[kk][ty * 4], a1 = *(const float4*)&As[kk][64 + ty * 4];
            const float4 b0 = *(const float4*)&Bs[kk][tx * 4], b1 = *(const float4*)&Bs[kk][64 + tx * 4];
            a[0] = a0.x; a[1] = a0.y; a[2] = a0.z; a[3] = a0.w; a[4] = a1.x; a[5] = a1.y; a[6] = a1.z; a[7] = a1.w;
            b[0] = b0.x; b[1] = b0.y; b[2] = b0.z; b[3] = b0.w; b[4] = b1.x; b[5] = b1.y; b[6] = b1.z; b[7] = b1.w;
#pragma unroll
            for (int i = 0; i < 8; ++i)
#pragma unroll
                for (int j = 0; j < 8; ++j) acc[i][j] = fmaf(a[i], b[j], acc[i][j]);
        }
        __syncthreads();
    }
#pragma unroll
    for (int i = 0; i < 8; ++i) {
        const int m = m0 + (i < 4 ? ty * 4 + i : 64 + ty * 4 + (i - 4));
#pragma unroll
        for (int jh = 0; jh < 2; ++jh) {
            const int n = n0 + jh * 64 + tx * 4;
            float4 o;
            float* op = (float*)&o;
#pragma unroll
            for (int j = 0; j < 4; ++j) {
                float v = acc[i][jh * 4 + j];
                if (EPI == 1) v = alpha * R[(size_t)m * ldr + n + j] + v;
                if (EPI == 2) { v = v > 0.f ? v : 0.f; v = v * v; }
                if (EPI == 3) v = R[(size_t)m * ldr + n + j] * sigmoidf_(v + bias[n + j]);
                op[j] = v;
            }
            *(float4*)(C + (size_t)m * ldc + n) = o;
        }
    }
}

__global__ void rotary_naive(float* H, int ld, int col0, int nheads, int hd, int rot, float theta, float sc) {
    const int half = rot / 2;
    const long idx = (long)blockIdx.x * blockDim.x + threadIdx.x;
    const long total = (long)L * nheads * half;
    if (idx >= total) return;
    const int j = (int)(idx % half); const int h = (int)((idx / half) % nheads); const int t = (int)(idx / ((long)half * nheads));
    const float inv_freq = 1.0f / powf(theta, (float)j / (float)half);
    const float ang = (float)t * inv_freq;
    const float c = cosf(ang), s = sinf(ang);
    float* p = H + (size_t)t * ld + col0 + h * hd;
    const float x1 = p[j], x2 = p[j + half];
    p[j] = (x1 * c - x2 * s) * sc; p[j + half] = (x2 * c + x1 * s) * sc;
}
__global__ void scale_cols_naive(float* H, int ld, int col0, int ncols, float sc) {
    const long idx = (long)blockIdx.x * blockDim.x + threadIdx.x;
    if (idx >= (long)L * ncols) return;
    const int c = (int)(idx % ncols); const int t = (int)(idx / ncols);
    H[(size_t)t * ld + col0 + c] *= sc;
}

__global__ void __launch_bounds__(64) s5_naive(const float* __restrict__ H0, const float* lam_re, const float* lam_im, const float* log_step,
                                               const float* b_re, const float* b_im, const float* c_re, const float* c_im, float* ys5) {
    __shared__ float us[64][16];
    __shared__ float hrs[64][65];
    __shared__ float his[64][65];
    __shared__ float cre[16][65];
    __shared__ float cim[16][65];
    const int dir = blockIdx.x >> 6, g = blockIdx.x & 63, p = threadIdx.x;
    const float lr = fminf(lam_re[(dir * 64 + g) * 64 + p], -1e-4f), li = lam_im[(dir * 64 + g) * 64 + p];
    const float step = expf(log_step[dir * 64 + g]);
    const float mag = expf(lr * step);
    const float ar = mag * cosf(li * step), ai = mag * sinf(li * step);
    const float nr = ar - 1.0f, ni = ai, den = lr * lr + li * li;
    const float zr = (nr * lr + ni * li) / den, zi = (ni * lr - nr * li) / den;
    float bbr[16], bbi[16];
#pragma unroll
    for (int c = 0; c < 16; ++c) {
        const float br = b_re[((size_t)(dir * 64 + g) * 64 + p) * 16 + c], bi = b_im[((size_t)(dir * 64 + g) * 64 + p) * 16 + c];
        bbr[c] = zr * br - zi * bi; bbi[c] = zr * bi + zi * br;
    }
    for (int i = p; i < 16 * 64; i += 64) { const int c = i >> 6, pp = i & 63;
        cre[c][pp] = c_re[((size_t)(dir * 64 + g) * 16 + c) * 64 + pp]; cim[c][pp] = c_im[((size_t)(dir * 64 + g) * 16 + c) * 64 + pp]; }
    float hr = 0.f, hi = 0.f;
    for (int n = 0; n < L / 64; ++n) {
        __syncthreads();
        for (int i = p; i < 64 * 16; i += 64) { const int tt = i >> 4, c = i & 15; const int s = n * 64 + tt; const int t = dir == 0 ? s : L - 1 - s;
            us[tt][c] = H0[(size_t)t * EW + g * 16 + c]; }
        __syncthreads();
        for (int tt = 0; tt < 64; ++tt) {
            float bur = 0.f, bui = 0.f;
#pragma unroll
            for (int c = 0; c < 16; ++c) { const float u = us[tt][c]; bur = fmaf(u, bbr[c], bur); bui = fmaf(u, bbi[c], bui); }
            const float nhr = ar * hr - ai * hi + bur, nhi = ar * hi + ai * hr + bui;
            hr = nhr; hi = nhi; hrs[tt][p] = hr; his[tt][p] = hi;
        }
        __syncthreads();
        const int c = p & 15, tq = p >> 4;
        for (int tt = tq * 16; tt < tq * 16 + 16; ++tt) {
            float y = 0.f;
            for (int pp = 0; pp < 64; ++pp) y += cre[c][pp] * hrs[tt][pp] - cim[c][pp] * his[tt][pp];
            const int s = n * 64 + tt; const int t = dir == 0 ? s : L - 1 - s;
            ys5[((size_t)dir * L + t) * 1024 + g * 16 + c] = y;
        }
    }
}
__global__ void s5_combine_naive(const float* ys5, const float* H0, const float* dskip, float* yg) {
    const long idx = (long)blockIdx.x * blockDim.x + threadIdx.x;
    if (idx >= (long)L * 1024) return;
    const int ch = (int)(idx & 1023); const int t = (int)(idx >> 10);
    const float y = ys5[idx] + ys5[(size_t)L * 1024 + idx] + dskip[ch] * H0[(size_t)t * EW + ch];
    yg[idx] = gelu_tanh(y);
}
__global__ void __launch_bounds__(256) ret_naive(const float* __restrict__ H0, const float* ret_log_decay, float* oret) {
    __shared__ float qs[16][256];
    __shared__ float ks[16][256];
    __shared__ float vs[16][16];
    const int et = blockIdx.x & 15, h = (blockIdx.x >> 4) & 3, dir = blockIdx.x >> 6;
    const int tid = threadIdx.x, dg = tid & 15, el = tid >> 4;
    const float gdec = expf(-fabsf(ret_log_decay[dir * 4 + h]));
    float S[16];
#pragma unroll
    for (int i = 0; i < 16; ++i) S[i] = 0.f;
    for (int n = 0; n < L / 16; ++n) {
        __syncthreads();
        for (int i = tid; i < 16 * 256; i += 256) { const int tt = i >> 8, d = i & 255; const int s = n * 16 + tt; const int t = dir == 0 ? s : L - 1 - s;
            qs[tt][d] = H0[(size_t)t * EW + 1024 + h * 256 + d]; ks[tt][d] = H0[(size_t)t * EW + 2048 + h * 256 + d]; }
        for (int i = tid; i < 16 * 16; i += 256) { const int tt = i >> 4, e = i & 15; const int s = n * 16 + tt; const int t = dir == 0 ? s : L - 1 - s;
            vs[tt][e] = H0[(size_t)t * EW + 3072 + h * 256 + et * 16 + e]; }
        __syncthreads();
        for (int tt = 0; tt < 16; ++tt) {
            const float v = vs[tt][el];
            float o = 0.f;
            if (dir == 0) {
#pragma unroll
                for (int i = 0; i < 16; ++i) { S[i] = gdec * S[i] + ks[tt][dg * 16 + i] * v; o = fmaf(qs[tt][dg * 16 + i], S[i], o); }
            } else {
#pragma unroll
                for (int i = 0; i < 16; ++i) { o = fmaf(qs[tt][dg * 16 + i], S[i], o); S[i] = gdec * (S[i] + ks[tt][dg * 16 + i] * v); }
            }
            o += __shfl_xor(o, 1); o += __shfl_xor(o, 2); o += __shfl_xor(o, 4); o += __shfl_xor(o, 8);
            if (dg == 0) { const int s = n * 16 + tt; const int t = dir == 0 ? s : L - 1 - s;
                oret[((size_t)dir * L + t) * 1024 + h * 256 + et * 16 + el] = o; }
        }
    }
}
__global__ void __launch_bounds__(256) ret_combine_naive(const float* oret, const float* H0, float* concat) {
    const int t = blockIdx.x, h = threadIdx.x >> 6, lane = threadIdx.x & 63;
    float o[4]; float s = 0.f;
#pragma unroll
    for (int i = 0; i < 4; ++i) { const int e = lane + 64 * i; o[i] = oret[(size_t)t * 1024 + h * 256 + e] + oret[((size_t)L + t) * 1024 + h * 256 + e]; s += o[i]; }
#pragma unroll
    for (int m = 1; m < 64; m <<= 1) s += __shfl_xor(s, m);
    const float mu = s * (1.0f / 256.0f); float q = 0.f;
#pragma unroll
    for (int i = 0; i < 4; ++i) { const float d = o[i] - mu; q += d * d; }
#pragma unroll
    for (int m = 1; m < 64; m <<= 1) q += __shfl_xor(q, m);
    const float rstd = rsqrtf(q * (1.0f / 256.0f) + 1e-6f);
#pragma unroll
    for (int i = 0; i < 4; ++i) { const int e = lane + 64 * i; const float gte = H0[(size_t)t * EW + 4096 + h * 256 + e];
        concat[(size_t)t * 2048 + 1024 + h * 256 + e] = (o[i] - mu) * rstd * (gte * sigmoidf_(gte)); }
}
__global__ void __launch_bounds__(256) ln_naive(const float* z, const float* g, const float* b, float* out) {
    __shared__ float red[8];
    const int t = blockIdx.x, tid = threadIdx.x;
    float v[8]; float s = 0.f;
#pragma unroll
    for (int i = 0; i < 8; ++i) { v[i] = z[(size_t)t * D + tid + 256 * i]; s += v[i]; }
#pragma unroll
    for (int m = 1; m < 64; m <<= 1) s += __shfl_xor(s, m);
    if ((tid & 63) == 0) red[tid >> 6] = s;
    __syncthreads();
    const float mu = (red[0] + red[1] + red[2] + red[3]) * (1.0f / D);
    float q = 0.f;
#pragma unroll
    for (int i = 0; i < 8; ++i) { const float d = v[i] - mu; q += d * d; }
#pragma unroll
    for (int m = 1; m < 64; m <<= 1) q += __shfl_xor(q, m);
    if ((tid & 63) == 0) red[4 + (tid >> 6)] = q;
    __syncthreads();
    const float rstd = rsqrtf((red[4] + red[5] + red[6] + red[7]) * (1.0f / D) + 1e-5f);
#pragma unroll
    for (int i = 0; i < 8; ++i) { const int c = tid + 256 * i; out[(size_t)t * D + c] = (v[i] - mu) * rstd * g[c] + b[c]; }
}
__global__ void __launch_bounds__(256) attn_naive(const float* __restrict__ H1, const float* sink, float* O) {
    __shared__ float qs[4][128];
    __shared__ float ps[4][320];
    const int w = threadIdx.x >> 6, lane = threadIdx.x & 63;
    const int idx = blockIdx.x * 4 + w; const int h = idx & 15, t = idx >> 4; const int kvh = h >> 2;
    qs[w][lane] = H1[(size_t)t * OW + h * 128 + lane]; qs[w][lane + 64] = H1[(size_t)t * OW + h * 128 + lane + 64];
    __syncthreads();
    const float scale = 0.08838834764831845f;
    float sc[5]; float mx = -1e30f;
#pragma unroll
    for (int r = 0; r < 5; ++r) {
        const int j = r * 64 + lane; const int kp = t - 128 + j; const bool valid = (j < 257) && kp >= 0 && kp < L;
        float s = -1e30f;
        if (valid) { const float* kr = H1 + (size_t)kp * OW + 2048 + kvh * 128; float a = 0.f;
            for (int d = 0; d < 128; ++d) a = fmaf(qs[w][d], kr[d], a);
            s = a * scale; }
        sc[r] = s; mx = fmaxf(mx, s);
    }
#pragma unroll
    for (int m = 1; m < 64; m <<= 1) mx = fmaxf(mx, __shfl_xor(mx, m));
    const float sk = sink[h]; mx = fmaxf(mx, sk);
    float sum = 0.f;
#pragma unroll
    for (int r = 0; r < 5; ++r) { sc[r] = expf(sc[r] - mx); sum += sc[r]; }
#pragma unroll
    for (int m = 1; m < 64; m <<= 1) sum += __shfl_xor(sum, m);
    const float inv = 1.0f / (sum + expf(sk - mx));
#pragma unroll
    for (int r = 0; r < 5; ++r) ps[w][r * 64 + lane] = sc[r] * inv;
    __syncthreads();
    float o0 = 0.f, o1 = 0.f;
    for (int j = 0; j < 257; ++j) { const int kp = t - 128 + j; if (kp < 0 || kp >= L) continue;
        const float p = ps[w][j]; const float* vr = H1 + (size_t)kp * OW + 2560 + kvh * 128;
        o0 = fmaf(p, vr[lane], o0); o1 = fmaf(p, vr[lane + 64], o1); }
    O[(size_t)t * D + h * 128 + lane] = o0; O[(size_t)t * D + h * 128 + lane + 64] = o1;
}

constexpr size_t MiB = 1u << 20;
struct NaiveBufs { float *H, *YS5, *ORET, *YG, *CONCAT, *XA, *HDN, *XB; };
static void forward_naive(void* const* d_in, float* out, unsigned char* ws, hipStream_t st) {
    const float* x = (const float*)d_in[0]; const float* ln_g = (const float*)d_in[1]; const float* ln_b = (const float*)d_in[2];
    const float* w1 = (const float*)d_in[3]; const float* w2 = (const float*)d_in[4];
    const float* ewin = (const float*)d_in[5]; const float* ewout = (const float*)d_in[6];
    const float* lam_re = (const float*)d_in[7]; const float* lam_im = (const float*)d_in[8]; const float* log_step = (const float*)d_in[9];
    const float* b_re = (const float*)d_in[10]; const float* b_im = (const float*)d_in[11]; const float* c_re = (const float*)d_in[12]; const float* c_im = (const float*)d_in[13];
    const float* s5d = (const float*)d_in[14]; const float* wglu = (const float*)d_in[15]; const float* bglu = (const float*)d_in[16]; const float* rld = (const float*)d_in[17];
    const float* owin = (const float*)d_in[18]; const float* owout = (const float*)d_in[19]; const float* sink = (const float*)d_in[20];
    float* H0 = (float*)(ws + 0 * MiB);
    float* YS5 = (float*)(ws + 160 * MiB);
    float* ORET = (float*)(ws + 224 * MiB);
    float* YG = (float*)(ws + 288 * MiB);
    float* CONCAT = (float*)(ws + 352 * MiB);
    float* XA = (float*)(ws + 416 * MiB);
    float* HDN = (float*)(ws + 0 * MiB);
    float* XB = (float*)(ws + 128 * MiB);
    float* H1 = (float*)(ws + 192 * MiB);
    float* OATT = (float*)(ws + 288 * MiB);
    float* XC = (float*)(ws + 352 * MiB);
    float* XD = (float*)(ws + 128 * MiB);
    const dim3 blk(256);
    gemm_naive<0><<<dim3(EW / 128, L / 128), blk, 0, st>>>(x, D, ewin, EW, H0, EW, D, nullptr, 0, 0.f, nullptr);
    rotary_naive<<<(L * 4 * 128 + 255) / 256, blk, 0, st>>>(H0, EW, 1024, 4, 256, 256, 10000.0f, 1.0f);
    rotary_naive<<<(L * 4 * 128 + 255) / 256, blk, 0, st>>>(H0, EW, 2048, 4, 256, 256, 10000.0f, 0.0625f);
    s5_naive<<<128, 64, 0, st>>>(H0, lam_re, lam_im, log_step, b_re, b_im, c_re, c_im, YS5);
    s5_combine_naive<<<(L * 1024) / 256, blk, 0, st>>>(YS5, H0, s5d, YG);
    gemm_naive<3><<<dim3(1024 / 128, L / 128), blk, 0, st>>>(YG, 1024, wglu, 1024, CONCAT, 2048, 1024, YG, 1024, 0.f, bglu);
    ret_naive<<<128, blk, 0, st>>>(H0, rld, ORET);
    ret_combine_naive<<<L, blk, 0, st>>>(ORET, H0, CONCAT);
    gemm_naive<1><<<dim3(D / 128, L / 128), blk, 0, st>>>(CONCAT, 2048, ewout, D, XA, D, 2048, x, D, ALPHA, nullptr);
    ln_naive<<<L, blk, 0, st>>>(XA, ln_g + 0 * D, ln_b + 0 * D, XA);
    for (int hf = 0; hf < 2; ++hf) {
        gemm_naive<2><<<dim3(DFF / 128, 4096 / 128), blk, 0, st>>>(XA + (size_t)hf * 4096 * D, D, w1, DFF, HDN, DFF, D, nullptr, 0, 0.f, nullptr);
        gemm_naive<1><<<dim3(D / 128, 4096 / 128), blk, 0, st>>>(HDN, DFF, w2, D, XB + (size_t)hf * 4096 * D, D, DFF, XA + (size_t)hf * 4096 * D, D, ALPHA, nullptr);
    }
    ln_naive<<<L, blk, 0, st>>>(XB, ln_g + 1 * D, ln_b + 1 * D, XB);
    gemm_naive<0><<<dim3(OW / 128, L / 128), blk, 0, st>>>(XB, D, owin, OW, H1, OW, D, nullptr, 0, 0.f, nullptr);
    rotary_naive<<<(L * 20 * 16 + 255) / 256, blk, 0, st>>>(H1, OW, 0, 20, 128, 32, 500000.0f, 1.0f);
    attn_naive<<<L * 16 / 4, blk, 0, st>>>(H1, sink, OATT);
    gemm_naive<1><<<dim3(D / 128, L / 128), blk, 0, st>>>(OATT, D, owout, D, XC, D, D, XB, D, ALPHA, nullptr);
    ln_naive<<<L, blk, 0, st>>>(XC, ln_g + 2 * D, ln_b + 2 * D, XC);
    const float* w1b = w1 + (size_t)D * DFF; const float* w2b = w2 + (size_t)DFF * D;
    for (int hf = 0; hf < 2; ++hf) {
        gemm_naive<2><<<dim3(DFF / 128, 4096 / 128), blk, 0, st>>>(XC + (size_t)hf * 4096 * D, D, w1b, DFF, HDN, DFF, D, nullptr, 0, 0.f, nullptr);
        gemm_naive<1><<<dim3(D / 128, 4096 / 128), blk, 0, st>>>(HDN, DFF, w2b, D, XD + (size_t)hf * 4096 * D, D, DFF, XC + (size_t)hf * 4096 * D, D, ALPHA, nullptr);
    }
    ln_naive<<<L, blk, 0, st>>>(XD, ln_g + 3 * D, ln_b + 3 * D, out);
}
}
extern "C" void kernel_launch(void* const* d_in, const int* in_sizes, int n_in, void* d_out, int out_size, void* d_ws, size_t ws_size, hipStream_t stream) {
    if (n_in != 21 || out_size != 8192 * 2048 || ws_size < (size_t)480 * nv::MiB) { fprintf(stderr, "kernel_launch: unexpected shapes (n_in %d out %d ws %zu)\n", n_in, out_size, ws_size); return; }
    nv::forward_naive(d_in, (float*)d_out, (unsigned char*)d_ws, stream);
}
```
